# Optimizing an MI355X kernel written in HIP

```python
import math
import jax, jax.numpy as jnp
from jax import lax
import numpy as np

D_MODEL = 1024
BATCH = 8
SEQ = 2048
DEPTH = 1

PLE_DIM = 256
SSD_HEADS = 16
SSD_HEAD_DIM = 64
SSD_INNER = SSD_HEADS * SSD_HEAD_DIM
SSD_GROUPS = 2
SSD_STATE = 128
SSD_CONV = 4
SSD_CHUNK = 128
MLA_HEADS = 16
MLA_Q_RANK = 384
MLA_KV_RANK = 256
MLA_NOPE = 64
MLA_ROPE = 32
MLA_V = 64
MLA_OUT = MLA_HEADS * MLA_V
ROPE_BASE = 10000.0
Q_BLOCK = 128
MIX_WIDTH = SSD_INNER + MLA_OUT
SSD_XBC = SSD_INNER + 2 * SSD_GROUPS * SSD_STATE
IN_WIDTH = SSD_INNER + SSD_XBC + SSD_HEADS + MLA_Q_RANK + MLA_KV_RANK + MLA_ROPE
D_FF = -(-8 * D_MODEL // (3 * 256)) * 256
DEEPNORM_ALPHA = (2 * DEPTH) ** 0.25
DEEPNORM_BETA = (8 * DEPTH) ** -0.25
EPS = 1e-6

kernel_name = "hybrid_ssd_mla_deepnorm_ple_layer"


def rmsnorm(u, g):
    uf = u.astype(jnp.float32)
    out = uf * lax.rsqrt(jnp.mean(uf * uf, axis=-1, keepdims=True) + EPS)
    return (out * g.astype(jnp.float32)).astype(u.dtype)


def layernorm(u, g, b):
    uf = u.astype(jnp.float32)
    mu = jnp.mean(uf, axis=-1, keepdims=True)
    d = uf - mu
    var = jnp.mean(d * d, axis=-1, keepdims=True)
    out = d * lax.rsqrt(var + 1e-5) * g.astype(jnp.float32) + b.astype(jnp.float32)
    return out.astype(u.dtype)


def rope_tables(positions):
    inv_freq = 1.0 / (ROPE_BASE ** (jnp.arange(0, MLA_ROPE, 2, dtype=jnp.float32) / MLA_ROPE))
    ang = positions.astype(jnp.float32)[..., None] * inv_freq
    return jnp.cos(ang), jnp.sin(ang)


def apply_rope(u, cos, sin):
    cos = cos.astype(u.dtype)
    sin = sin.astype(u.dtype)
    u1, u2 = jnp.split(u, 2, axis=-1)
    return jnp.concatenate([u1 * cos - u2 * sin, u2 * cos + u1 * sin], axis=-1)


def causal_depthwise_conv(u, w, bias):
    c = u.shape[-1]
    out = lax.conv_general_dilated(
        u, w[:, None, :].astype(u.dtype), window_strides=(1,),
        padding=((SSD_CONV - 1, 0),), dimension_numbers=("NWC", "WIO", "NWC"),
        feature_group_count=c)
    return out + bias.astype(u.dtype)


def ssd_mixer(z, xBC, dt_raw, conv_w, conv_b, dt_bias, A_log, D_skip, norm_w):
    b, s, _ = xBC.shape
    G, E, P, N, L = SSD_GROUPS, SSD_HEADS // SSD_GROUPS, SSD_HEAD_DIM, SSD_STATE, SSD_CHUNK
    nc = s // L
    f32 = jnp.float32
    xBC = jax.nn.silu(causal_depthwise_conv(xBC, conv_w, conv_b))
    xs, Bm, Cm = jnp.split(xBC, [SSD_INNER, SSD_INNER + G * N], axis=-1)
    xs = xs.astype(f32).reshape(b, nc, L, G, E, P)
    Bm = Bm.astype(f32).reshape(b, nc, L, G, N)
    Cm = Cm.astype(f32).reshape(b, nc, L, G, N)
    dt = jax.nn.softplus(dt_raw.astype(f32) + dt_bias.astype(f32))
    A = -jnp.exp(A_log.astype(f32))
    dt_c = dt.reshape(b, nc, L, G, E)
    dA_cs = jnp.cumsum((dt * A).reshape(b, nc, L, G, E).transpose(0, 1, 3, 4, 2), axis=-1)
    X = xs * dt_c[..., None]
    causal = jnp.tril(jnp.ones((L, L), dtype=bool))
    seg = dA_cs[..., :, None] - dA_cs[..., None, :]
    Lmat = jnp.exp(jnp.where(causal, seg, -jnp.inf))
    CB = jnp.einsum("bclgn,bcsgn->bcgls", Cm, Bm)
    y_diag = jnp.einsum("bcgls,bcgels,bcsgep->bclgep", CB, Lmat, X)
    decay_states = jnp.exp(dA_cs[..., -1:] - dA_cs)
    states = jnp.einsum("bclgn,bcgel,bclgep->bcgepn", Bm, decay_states, X)
    chunk_decay = jnp.exp(dA_cs[..., -1])

    def step(carry, inp):
        dec, st = inp
        return carry * dec[..., None, None] + st, carry

    init = jnp.zeros((b, G, E, P, N), f32)
    _, prev = lax.scan(step, init, (chunk_decay.transpose(1, 0, 2, 3), states.transpose(1, 0, 2, 3, 4, 5)))
    prev = prev.transpose(1, 0, 2, 3, 4, 5)
    y_off = jnp.einsum("bclgn,bcgepn,bcgel->bclgep", Cm, prev, jnp.exp(dA_cs))
    y = y_diag + y_off + D_skip.astype(f32).reshape(G, E)[:, :, None] * xs
    y = y.reshape(b, s, SSD_INNER)
    y = rmsnorm(y * jax.nn.silu(z.astype(f32)), norm_w)
    return y.astype(z.dtype)


def mla_mixer(q_c, kv_c, k_rope, cos, sin, q_norm_w, w_q_b, kv_norm_w, w_kv_b, out_norm_w):
    b, s, _ = q_c.shape
    H = MLA_HEADS
    q = (rmsnorm(q_c, q_norm_w) @ w_q_b).reshape(b, s, H, MLA_NOPE + MLA_ROPE)
    q_nope, q_rope = jnp.split(q, [MLA_NOPE], axis=-1)
    kv = (rmsnorm(kv_c, kv_norm_w) @ w_kv_b).reshape(b, s, H, MLA_NOPE + MLA_V)
    k_nope, v = jnp.split(kv, [MLA_NOPE], axis=-1)
    q_rope = apply_rope(q_rope, cos[:, :, None, :], sin[:, :, None, :])
    k_rope = apply_rope(k_rope, cos, sin)
    scale = 1.0 / math.sqrt(MLA_NOPE + MLA_ROPE)
    nb = s // Q_BLOCK
    qn_blocks = q_nope.reshape(b, nb, Q_BLOCK, H, MLA_NOPE).transpose(1, 0, 2, 3, 4)
    qr_blocks = q_rope.reshape(b, nb, Q_BLOCK, H, MLA_ROPE).transpose(1, 0, 2, 3, 4)
    key_idx = jnp.arange(s)

    def attend(args):
        qn, qr, blk = args
        sc = (jnp.einsum("bqhd,bkhd->bhqk", qn, k_nope).astype(jnp.float32)
              + jnp.einsum("bqhr,bkr->bhqk", qr, k_rope).astype(jnp.float32)) * scale
        q_idx = blk * Q_BLOCK + jnp.arange(Q_BLOCK)
        sc = jnp.where(q_idx[:, None] >= key_idx[None, :], sc, -jnp.inf)
        pr = jax.nn.softmax(sc, axis=-1).astype(v.dtype)
        return jnp.einsum("bhqk,bkhd->bqhd", pr, v)

    out = lax.map(attend, (qn_blocks, qr_blocks, jnp.arange(nb)))
    out = out.transpose(1, 0, 2, 3, 4).reshape(b, s, MLA_OUT)
    return rmsnorm(out, out_norm_w)


def setup_inputs(seed: int = 0) -> dict:
    key = jax.random.key(seed)
    ks = iter(jax.random.split(key, 40))
    f32 = jnp.float32

    def w(shape, fan_in, scale=1.0):
        return jax.random.normal(next(ks), shape, f32) * (fan_in ** -0.5) * scale

    def gain(shape):
        return 1.0 + 0.02 * jax.random.normal(next(ks), shape, f32)

    def small(shape):
        return 0.02 * jax.random.normal(next(ks), shape, f32)

    x = jax.random.normal(next(ks), (BATCH, SEQ, D_MODEL), f32)
    p = jax.random.normal(next(ks), (DEPTH, BATCH, SEQ, PLE_DIM), f32)
    offsets = jax.random.randint(next(ks), (BATCH, 1), 0, 1024, dtype=jnp.int32)
    positions = (jnp.arange(SEQ, dtype=jnp.int32)[None, :] + offsets).astype(jnp.int32)

    dt0 = jnp.exp(jax.random.uniform(next(ks), (DEPTH, SSD_HEADS), f32) * (math.log(0.1) - math.log(0.001)) + math.log(0.001))
    ssd_dt_bias = dt0 + jnp.log(-jnp.expm1(-dt0))
    ssd_A_log = jnp.log(jax.random.uniform(next(ks), (DEPTH, SSD_HEADS), f32, 1.0, 16.0))

    return {
        "x": x,
        "p": p,
        "positions": positions,
        "w_in": w((DEPTH, D_MODEL, IN_WIDTH), D_MODEL),
        "ssd_conv_w": w((DEPTH, SSD_CONV, SSD_XBC), SSD_CONV),
        "ssd_conv_b": small((DEPTH, SSD_XBC)),
        "ssd_dt_bias": ssd_dt_bias,
        "ssd_A_log": ssd_A_log,
        "ssd_D": gain((DEPTH, SSD_HEADS)),
        "ssd_norm_w": gain((DEPTH, SSD_INNER)),
        "mla_q_norm_w": gain((DEPTH, MLA_Q_RANK)),
        "mla_w_q_b": w((DEPTH, MLA_Q_RANK, MLA_HEADS * (MLA_NOPE + MLA_ROPE)), MLA_Q_RANK),
        "mla_kv_norm_w": gain((DEPTH, MLA_KV_RANK)),
        "mla_w_kv_b": w((DEPTH, MLA_KV_RANK, MLA_HEADS * (MLA_NOPE + MLA_V)), MLA_KV_RANK),
        "mla_out_norm_w": gain((DEPTH, MLA_OUT)),
        "w_out": w((DEPTH, MIX_WIDTH, D_MODEL), MIX_WIDTH, DEEPNORM_BETA),
        "ln_mix_g": gain((DEPTH, D_MODEL)),
        "ln_mix_b": small((DEPTH, D_MODEL)),
        "w_ffn_gate": w((DEPTH, D_MODEL, D_FF), D_MODEL),
        "w_ffn_up": w((DEPTH, D_MODEL, D_FF), D_MODEL),
        "w_ffn_down": w((DEPTH, D_FF, D_MODEL), D_FF, DEEPNORM_BETA),
        "w_ple_gate": w((DEPTH, D_MODEL, D_MODEL), D_MODEL),
        "w_ple_proj": w((DEPTH, PLE_DIM, D_MODEL), PLE_DIM, DEEPNORM_BETA),
        "ln_ffn_g": gain((DEPTH, D_MODEL)),
        "ln_ffn_b": small((DEPTH, D_MODEL)),
    }


def reference(x, p, positions, w_in, ssd_conv_w, ssd_conv_b, ssd_dt_bias, ssd_A_log, ssd_D, ssd_norm_w,
              mla_q_norm_w, mla_w_q_b, mla_kv_norm_w, mla_w_kv_b, mla_out_norm_w, w_out,
              ln_mix_g, ln_mix_b, w_ffn_gate, w_ffn_up, w_ffn_down, w_ple_gate, w_ple_proj,
              ln_ffn_g, ln_ffn_b):
    s0 = SSD_INNER
    s1 = s0 + SSD_XBC
    s2 = s1 + SSD_HEADS
    s3 = s2 + MLA_Q_RANK
    s4 = s3 + MLA_KV_RANK
    splits = [s0, s1, s2, s3, s4]
    cos, sin = rope_tables(positions)
    h = x
    for i in range(DEPTH):
        proj = h @ w_in[i]
        z, xBC, dt_raw, q_c, kv_c, k_rope = jnp.split(proj, splits, axis=-1)
        y_ssd = ssd_mixer(z, xBC, dt_raw, ssd_conv_w[i], ssd_conv_b[i], ssd_dt_bias[i],
                          ssd_A_log[i], ssd_D[i], ssd_norm_w[i])
        y_mla = mla_mixer(q_c, kv_c, k_rope, cos, sin, mla_q_norm_w[i], mla_w_q_b[i],
                          mla_kv_norm_w[i], mla_w_kv_b[i], mla_out_norm_w[i])
        mix = jnp.concatenate([y_ssd, y_mla], axis=-1) @ w_out[i]
        h = layernorm(DEEPNORM_ALPHA * h + mix, ln_mix_g[i], ln_mix_b[i])
        ffn = (jax.nn.silu(h @ w_ffn_gate[i]) * (h @ w_ffn_up[i])) @ w_ffn_down[i]
        ple = jax.nn.sigmoid(h @ w_ple_gate[i]) * (p[i] @ w_ple_proj[i])
        h = layernorm(DEEPNORM_ALPHA * h + ffn + ple, ln_ffn_g[i], ln_ffn_b[i])
    return h
```

```cpp
#include <hip/hip_runtime.h>
#include <cstdio>
#include <cstdint>
#include <cmath>

constexpr int D_MODEL = 1024, BATCH = 8, SEQ = 2048;
constexpr int PLE_DIM = 256;
constexpr int SSD_HEADS = 16, SSD_HEAD_DIM = 64, SSD_INNER = 1024, SSD_GROUPS = 2, SSD_STATE = 128, SSD_CONV = 4;
constexpr int MLA_HEADS = 16, MLA_Q_RANK = 384, MLA_KV_RANK = 256, MLA_NOPE = 64, MLA_ROPE = 32, MLA_V = 64, MLA_OUT = 1024;
constexpr int MIX_WIDTH = 2048;
constexpr int SSD_XBC = SSD_INNER + 2 * SSD_GROUPS * SSD_STATE;
constexpr int IN_WIDTH = SSD_INNER + SSD_XBC + SSD_HEADS + MLA_Q_RANK + MLA_KV_RANK + MLA_ROPE;
constexpr int D_FF = 2816;
constexpr float ALPHA = 1.189207115002721f;
constexpr float EPS = 1e-6f;
constexpr int C_Z = 0, C_XBC = 1024, C_DT = 2560, C_QC = 2576, C_KVC = 2960, C_KR = 3216;

__global__ void __launch_bounds__(256) gemm_naive(const float* __restrict__ A, int lda, const float* __restrict__ B, int ldb, float* __restrict__ C, int ldc, int M, int N, int K) {
    __shared__ float As[16][64 + 1];
    __shared__ float Bs[16][64 + 1];
    const int tx = threadIdx.x & 15, ty = threadIdx.x >> 4;
    const int m0 = blockIdx.y * 64, n0 = blockIdx.x * 64;
    float acc[4][4];
#pragma unroll
    for (int i = 0; i < 4; ++i)
#pragma unroll
        for (int j = 0; j < 4; ++j) acc[i][j] = 0.f;
    for (int k0 = 0; k0 < K; k0 += 16) {
#pragma unroll
        for (int i = 0; i < 4; ++i) {
            const int idx = threadIdx.x + i * 256;
            const int r = idx >> 4, c = idx & 15;
            As[c][r] = A[(size_t)(m0 + r) * lda + k0 + c];
        }
#pragma unroll
        for (int i = 0; i < 4; ++i) {
            const int idx = threadIdx.x + i * 256;
            const int r = idx >> 6, c = idx & 63;
            const int n = n0 + c;
            Bs[r][c] = (n < N) ? B[(size_t)(k0 + r) * ldb + n] : 0.f;
        }
        __syncthreads();
#pragma unroll
        for (int kk = 0; kk < 16; ++kk) {
            float a[4], b[4];
#pragma unroll
            for (int i = 0; i < 4; ++i) a[i] = As[kk][ty * 4 + i];
#pragma unroll
            for (int j = 0; j < 4; ++j) b[j] = Bs[kk][tx * 4 + j];
#pragma unroll
            for (int i = 0; i < 4; ++i)
#pragma unroll
                for (int j = 0; j < 4; ++j) acc[i][j] = fmaf(a[i], b[j], acc[i][j]);
        }
        __syncthreads();
    }
#pragma unroll
    for (int i = 0; i < 4; ++i)
#pragma unroll
        for (int j = 0; j < 4; ++j) {
            const int n = n0 + tx * 4 + j;
            if (n < N) C[(size_t)(m0 + ty * 4 + i) * ldc + n] = acc[i][j];
        }
}

__device__ __forceinline__ float siluf(float v) { return v / (1.f + expf(-v)); }
__device__ __forceinline__ float sigmoidf_(float v) { return 1.f / (1.f + expf(-v)); }
__device__ __forceinline__ float softplusf_(float v) { return v > 20.f ? v : log1pf(expf(v)); }

__device__ __forceinline__ float block_sum(float v, float* red) {
#pragma unroll
    for (int o = 32; o > 0; o >>= 1) v += __shfl_xor(v, o);
    const int w = threadIdx.x >> 6;
    __syncthreads();
    if ((threadIdx.x & 63) == 0) red[w] = v;
    __syncthreads();
    return red[0] + red[1] + red[2] + red[3];
}

__global__ void conv_silu_k(const float* __restrict__ proj, const float* __restrict__ cw, const float* __restrict__ cb, float* __restrict__ xa) {
    const int idx = blockIdx.x * 256 + threadIdx.x;
    if (idx >= SEQ * SSD_XBC) return;
    const int t = idx / SSD_XBC, c = idx % SSD_XBC;
    float acc = cb[c];
#pragma unroll
    for (int k = 0; k < SSD_CONV; ++k) {
        const int tt = t - (SSD_CONV - 1) + k;
        if (tt >= 0) acc += cw[k * SSD_XBC + c] * proj[(size_t)tt * IN_WIDTH + C_XBC + c];
    }
    xa[idx] = siluf(acc);
}

__global__ void dt_k(const float* __restrict__ proj, const float* __restrict__ dtb, float* __restrict__ dt) {
    const int idx = blockIdx.x * 256 + threadIdx.x;
    if (idx >= SEQ * SSD_HEADS) return;
    const int t = idx / SSD_HEADS, h = idx % SSD_HEADS;
    dt[idx] = softplusf_(proj[(size_t)t * IN_WIDTH + C_DT + h] + dtb[h]);
}

__global__ void __launch_bounds__(256) ssd_rec_k(const float* __restrict__ xa, const float* __restrict__ dt, const float* __restrict__ A_log, const float* __restrict__ Dsk, float* __restrict__ y) {
    __shared__ float Bsh[16][128];
    __shared__ float Csh[16][128];
    const int h = blockIdx.x, g = h / 8;
    const int p = threadIdx.x >> 2, nq = threadIdx.x & 3;
    const float A = -expf(A_log[h]);
    const float Dh = Dsk[h];
    float s[32];
#pragma unroll
    for (int j = 0; j < 32; ++j) s[j] = 0.f;
    for (int t0 = 0; t0 < SEQ; t0 += 16) {
        __syncthreads();
        for (int i = threadIdx.x; i < 16 * 128; i += 256) {
            const int r = i >> 7, n = i & 127;
            Bsh[r][n] = xa[(size_t)(t0 + r) * SSD_XBC + SSD_INNER + g * 128 + n];
            Csh[r][n] = xa[(size_t)(t0 + r) * SSD_XBC + SSD_INNER + 256 + g * 128 + n];
        }
        __syncthreads();
        for (int r = 0; r < 16; ++r) {
            const int t = t0 + r;
            const float dtv = dt[t * SSD_HEADS + h];
            const float a = expf(dtv * A);
            const float xv = xa[(size_t)t * SSD_XBC + h * 64 + p];
            const float xd = xv * dtv;
            float acc = 0.f;
#pragma unroll
            for (int j = 0; j < 32; ++j) {
                s[j] = s[j] * a + xd * Bsh[r][nq * 32 + j];
                acc = fmaf(Csh[r][nq * 32 + j], s[j], acc);
            }
            acc += __shfl_xor(acc, 1);
            acc += __shfl_xor(acc, 2);
            if (nq == 0) y[(size_t)t * SSD_INNER + h * 64 + p] = acc + Dh * xv;
        }
    }
}

__global__ void __launch_bounds__(256) ssd_gate_norm_k(const float* __restrict__ y, const float* __restrict__ proj, const float* __restrict__ w, float* __restrict__ ycat) {
    __shared__ float red[4];
    const int t = blockIdx.x;
    float v[4]; float ss = 0.f;
#pragma unroll
    for (int i = 0; i < 4; ++i) {
        const int c = threadIdx.x + i * 256;
        v[i] = y[(size_t)t * SSD_INNER + c] * siluf(proj[(size_t)t * IN_WIDTH + C_Z + c]);
        ss += v[i] * v[i];
    }
    ss = block_sum(ss, red);
    const float r = 1.f / sqrtf(ss / SSD_INNER + EPS);
#pragma unroll
    for (int i = 0; i < 4; ++i) {
        const int c = threadIdx.x + i * 256;
        ycat[(size_t)t * MIX_WIDTH + c] = v[i] * r * w[c];
    }
}

__global__ void __launch_bounds__(256) rmsnorm_k(const float* __restrict__ in, int ldi, const float* __restrict__ w, float* __restrict__ out, int ldo, int n) {
    __shared__ float red[4];
    const int t = blockIdx.x;
    float ss = 0.f;
    for (int c = threadIdx.x; c < n; c += 256) { const float v = in[(size_t)t * ldi + c]; ss += v * v; }
    ss = block_sum(ss, red);
    const float r = 1.f / sqrtf(ss / n + EPS);
    for (int c = threadIdx.x; c < n; c += 256) out[(size_t)t * ldo + c] = in[(size_t)t * ldi + c] * r * w[c];
}

__global__ void rope_k(float* __restrict__ q, const float* __restrict__ proj, float* __restrict__ krope, const int* __restrict__ pos) {
    const int idx = blockIdx.x * 256 + threadIdx.x;
    if (idx >= SEQ * 17 * 16) return;
    const int i = idx & 15, hh = (idx >> 4) % 17, t = idx / (17 * 16);
    const float inv_freq = 1.0f / powf(10000.0f, (float)(2 * i) / 32.0f);
    const float ang = (float)pos[t] * inv_freq;
    const float c = cosf(ang), s = sinf(ang);
    if (hh < 16) {
        float* qp = q + (size_t)t * 1536 + hh * 96 + 64;
        const float u1 = qp[i], u2 = qp[16 + i];
        qp[i] = u1 * c - u2 * s; qp[16 + i] = u2 * c + u1 * s;
    } else {
        const float* kp = proj + (size_t)t * IN_WIDTH + C_KR;
        const float u1 = kp[i], u2 = kp[16 + i];
        krope[t * 32 + i] = u1 * c - u2 * s; krope[t * 32 + 16 + i] = u2 * c + u1 * s;
    }
}

__global__ void __launch_bounds__(256) attn_naive_k(const float* __restrict__ q, const float* __restrict__ kv, const float* __restrict__ krope, float* __restrict__ o) {
    __shared__ float sc[4][SEQ];
    __shared__ float qs[4][96];
    const int w = threadIdx.x >> 6, lane = threadIdx.x & 63;
    const int h = blockIdx.y, qi = blockIdx.x * 4 + w;
    const float scale = 1.0f / sqrtf(96.f);
    for (int d = lane; d < 96; d += 64) qs[w][d] = q[(size_t)qi * 1536 + h * 96 + d];
    __syncthreads();
    float mx = -INFINITY;
    for (int key = lane; key <= qi; key += 64) {
        const float* kp = kv + (size_t)key * 2048 + h * 128;
        const float* rp = krope + (size_t)key * 32;
        float s = 0.f;
        for (int d = 0; d < 64; ++d) s = fmaf(qs[w][d], kp[d], s);
        for (int d = 0; d < 32; ++d) s = fmaf(qs[w][64 + d], rp[d], s);
        s *= scale;
        sc[w][key] = s;
        mx = fmaxf(mx, s);
    }
#pragma unroll
    for (int off = 32; off > 0; off >>= 1) mx = fmaxf(mx, __shfl_xor(mx, off));
    float sum = 0.f;
    for (int key = lane; key <= qi; key += 64) { const float e = expf(sc[w][key] - mx); sc[w][key] = e; sum += e; }
#pragma unroll
    for (int off = 32; off > 0; off >>= 1) sum += __shfl_xor(sum, off);
    __syncthreads();
    float acc = 0.f;
    for (int key = 0; key <= qi; ++key) acc = fmaf(sc[w][key], kv[(size_t)key * 2048 + h * 128 + 64 + lane], acc);
    o[(size_t)qi * 1024 + h * 64 + lane] = acc / sum;
}

__global__ void __launch_bounds__(256) ln_k(const float* __restrict__ a, const float* __restrict__ b1, const float* __restrict__ b2, const float* __restrict__ g, const float* __restrict__ beta, float* __restrict__ out) {
    __shared__ float red[4];
    const int t = blockIdx.x;
    float v[4]; float s = 0.f;
#pragma unroll
    for (int i = 0; i < 4; ++i) {
        const int c = threadIdx.x + i * 256;
        float x = ALPHA * a[(size_t)t * 1024 + c] + b1[(size_t)t * 1024 + c];
        if (b2) x += b2[(size_t)t * 1024 + c];
        v[i] = x; s += x;
    }
    s = block_sum(s, red);
    const float mu = s / 1024.f;
    float q = 0.f;
#pragma unroll
    for (int i = 0; i < 4; ++i) { const float d = v[i] - mu; q += d * d; }
    q = block_sum(q, red);
    const float r = 1.f / sqrtf(q / 1024.f + 1e-5f);
#pragma unroll
    for (int i = 0; i < 4; ++i) {
        const int c = threadIdx.x + i * 256;
        out[(size_t)t * 1024 + c] = (v[i] - mu) * r * g[c] + beta[c];
    }
}

__global__ void swiglu_k(const float* __restrict__ g, const float* __restrict__ u, float* __restrict__ o, int n) {
    const int idx = blockIdx.x * 256 + threadIdx.x;
    if (idx < n) o[idx] = siluf(g[idx]) * u[idx];
}
__global__ void sigmul_k(const float* __restrict__ g, const float* __restrict__ u, float* __restrict__ o, int n) {
    const int idx = blockIdx.x * 256 + threadIdx.x;
    if (idx < n) o[idx] = sigmoidf_(g[idx]) * u[idx];
}

static void gemm(const float* A, int lda, const float* B, int ldb, float* C, int ldc, int M, int N, int K, hipStream_t s) {
    dim3 grid((N + 63) / 64, M / 64);
    hipLaunchKernelGGL(gemm_naive, grid, dim3(256), 0, s, A, lda, B, ldb, C, ldc, M, N, K);
}

extern "C" void kernel_launch(void* const* d_in, const int* in_sizes, int n_in, void* d_out, int out_size, void* d_ws, size_t ws_size, hipStream_t stream) {
    const float* x = (const float*)d_in[0];
    const float* p = (const float*)d_in[1];
    const int* positions = (const int*)d_in[2];
    const float* w_in = (const float*)d_in[3];
    const float* conv_w = (const float*)d_in[4];
    const float* conv_b = (const float*)d_in[5];
    const float* dt_bias = (const float*)d_in[6];
    const float* A_log = (const float*)d_in[7];
    const float* Dsk = (const float*)d_in[8];
    const float* ssd_norm_w = (const float*)d_in[9];
    const float* q_norm_w = (const float*)d_in[10];
    const float* w_q_b = (const float*)d_in[11];
    const float* kv_norm_w = (const float*)d_in[12];
    const float* w_kv_b = (const float*)d_in[13];
    const float* out_norm_w = (const float*)d_in[14];
    const float* w_out = (const float*)d_in[15];
    const float* ln_mix_g = (const float*)d_in[16];
    const float* ln_mix_b = (const float*)d_in[17];
    const float* w_gate = (const float*)d_in[18];
    const float* w_up = (const float*)d_in[19];
    const float* w_down = (const float*)d_in[20];
    const float* w_pg = (const float*)d_in[21];
    const float* w_pp = (const float*)d_in[22];
    const float* ln_ffn_g = (const float*)d_in[23];
    const float* ln_ffn_b = (const float*)d_in[24];
    float* out = (float*)d_out;

    float* ws = (float*)d_ws;
    size_t off = 0;
    auto take = [&](size_t n) { float* r = ws + off; off += (n + 63) / 64 * 64; return r; };
    float* proj = take((size_t)SEQ * IN_WIDTH);
    float* xa = take((size_t)SEQ * SSD_XBC);
    float* dt = take((size_t)SEQ * 16);
    float* yraw = take((size_t)SEQ * 1024);
    float* qn = take((size_t)SEQ * 384);
    float* kvn = take((size_t)SEQ * 256);
    float* q = take((size_t)SEQ * 1536);
    float* kv = take((size_t)SEQ * 2048);
    float* krope = take((size_t)SEQ * 32);
    float* o = take((size_t)SEQ * 1024);
    float* ycat = take((size_t)SEQ * 2048);
    float* mix = take((size_t)SEQ * 1024);
    float* h1 = take((size_t)SEQ * 1024);
    float* gbuf = take((size_t)SEQ * D_FF);
    float* ubuf = take((size_t)SEQ * D_FF);
    float* dn = take((size_t)SEQ * 1024);
    float* pg = take((size_t)SEQ * 1024);
    float* pp = take((size_t)SEQ * 1024);
    if (off * 4 > ws_size) { fprintf(stderr, "workspace too small\n"); return; }

    for (int b = 0; b < BATCH; ++b) {
        const float* xb = x + (size_t)b * SEQ * D_MODEL;
        const float* pb = p + (size_t)b * SEQ * PLE_DIM;
        const int* posb = positions + (size_t)b * SEQ;
        float* outb = out + (size_t)b * SEQ * D_MODEL;
        gemm(xb, D_MODEL, w_in, IN_WIDTH, proj, IN_WIDTH, SEQ, IN_WIDTH, D_MODEL, stream);
        hipLaunchKernelGGL(conv_silu_k, dim3((SEQ * SSD_XBC + 255) / 256), dim3(256), 0, stream, proj, conv_w, conv_b, xa);
        hipLaunchKernelGGL(dt_k, dim3((SEQ * 16 + 255) / 256), dim3(256), 0, stream, proj, dt_bias, dt);
        hipLaunchKernelGGL(ssd_rec_k, dim3(16), dim3(256), 0, stream, xa, dt, A_log, Dsk, yraw);
        hipLaunchKernelGGL(ssd_gate_norm_k, dim3(SEQ), dim3(256), 0, stream, yraw, proj, ssd_norm_w, ycat);
        hipLaunchKernelGGL(rmsnorm_k, dim3(SEQ), dim3(256), 0, stream, proj + C_QC, IN_WIDTH, q_norm_w, qn, 384, 384);
        hipLaunchKernelGGL(rmsnorm_k, dim3(SEQ), dim3(256), 0, stream, proj + C_KVC, IN_WIDTH, kv_norm_w, kvn, 256, 256);
        gemm(qn, 384, w_q_b, 1536, q, 1536, SEQ, 1536, 384, stream);
        gemm(kvn, 256, w_kv_b, 2048, kv, 2048, SEQ, 2048, 256, stream);
        hipLaunchKernelGGL(rope_k, dim3((SEQ * 17 * 16 + 255) / 256), dim3(256), 0, stream, q, proj, krope, posb);
        hipLaunchKernelGGL(attn_naive_k, dim3(SEQ / 4, 16), dim3(256), 0, stream, q, kv, krope, o);
        hipLaunchKernelGGL(rmsnorm_k, dim3(SEQ), dim3(256), 0, stream, o, 1024, out_norm_w, ycat + 1024, 2048, 1024);
        gemm(ycat, 2048, w_out, 1024, mix, 1024, SEQ, 1024, 2048, stream);
        hipLaunchKernelGGL(ln_k, dim3(SEQ), dim3(256), 0, stream, xb, mix, (const float*)nullptr, ln_mix_g, ln_mix_b, h1);
        gemm(h1, 1024, w_gate, D_FF, gbuf, D_FF, SEQ, D_FF, 1024, stream);
        gemm(h1, 1024, w_up, D_FF, ubuf, D_FF, SEQ, D_FF, 1024, stream);
        hipLaunchKernelGGL(swiglu_k, dim3((SEQ * D_FF + 255) / 256), dim3(256), 0, stream, gbuf, ubuf, gbuf, SEQ * D_FF);
        gemm(gbuf, D_FF, w_down, 1024, dn, 1024, SEQ, 1024, D_FF, stream);
        gemm(h1, 1024, w_pg, 1024, pg, 1024, SEQ, 1024, 1024, stream);
        gemm(pb, 256, w_pp, 1024, pp, 1024, SEQ, 1024, 256, stream);
        hipLaunchKernelGGL(sigmul_k, dim3((SEQ * 1024 + 255) / 256), dim3(256), 0, stream, pg, pp, pg, SEQ * 1024);
        hipLaunchKernelGGL(ln_k, dim3(SEQ), dim3(256), 0, stream, h1, dn, pg, ln_ffn_g, ln_ffn_b, outb);
    }
}
```
